# Optimizing an MI355X kernel written in HIP

```python
import jax, jax.numpy as jnp
from jax import lax
import numpy as np

D_MODEL = 1024
BATCH = 8
SEQ = 2048
DEPTH = 1
DEC_BATCH = 16
DEC_SEQ = 64
PAST_LEN = 4096

CHUNK = 64
N_META = 16
POOL_W = D_MODEL // 2
POOL_WINDOWS = (2, 4, 8, 16)
N_POOL_GROUPS = len(POOL_WINDOWS)
POOL_GC = POOL_W // N_POOL_GROUPS
POOL_STATE = max(POOL_WINDOWS) - 1
SB_HEADS = 8
SB_HEAD_DIM = 64
ATTN_W = SB_HEADS * SB_HEAD_DIM
QBLOCK = 128
D_FF = 4 * D_MODEL
IN_W = POOL_W + 3 * ATTN_W + 2 * D_MODEL
LN_EPS = 1e-5
ALPHA = (2.0 * DEPTH) ** 0.25
BETA_INIT = (8.0 * DEPTH) ** -0.25
SB_SCALE = SB_HEAD_DIM ** -0.5

kernel_name = "hybrid_pool_stickbreak_streaming_step"


def _layer_norm(x, g, b):
    xf = x.astype(jnp.float32)
    mu = jnp.mean(xf, axis=-1, keepdims=True)
    var = jnp.mean(jnp.square(xf - mu), axis=-1, keepdims=True)
    return ((xf - mu) * lax.rsqrt(var + LN_EPS) * g + b).astype(x.dtype)


def _multiscale_pool(u, u_past, n_past):
    B, T, C = u.shape
    full = jnp.concatenate([u_past, u], axis=1)
    csum = jnp.concatenate([jnp.zeros((B, 1, C), jnp.float32),
                            jnp.cumsum(full.astype(jnp.float32), axis=1)], axis=1)
    hi = csum[:, POOL_STATE + 1:]
    pos = jnp.arange(T)
    outs = []
    for g, w in enumerate(POOL_WINDOWS):
        sl = slice(g * POOL_GC, (g + 1) * POOL_GC)
        lo = csum[:, POOL_STATE + 1 - w: POOL_STATE + 1 - w + T, sl]
        cnt = jnp.minimum(w, n_past + pos + 1).astype(jnp.float32)[None, :, None]
        outs.append((hi[..., sl] - lo) / cnt)
    mean = jnp.concatenate(outs, axis=-1)
    pooled = (mean - u.astype(jnp.float32)).astype(u.dtype)
    return pooled, full[:, -POOL_STATE:]


def _sb_block(q_blk, q_idx, keys, vals):
    z = jnp.einsum('bqhd,bkhd->bhqk', q_blk, keys).astype(jnp.float32) * SB_SCALE
    visible = jnp.arange(keys.shape[1])[None, :] < q_idx[:, None]
    log_keep = jnp.where(visible, jax.nn.log_sigmoid(-z), 0.0)
    tail = lax.cumsum(log_keep, axis=3, reverse=True) - log_keep
    weight = jnp.where(visible, jnp.exp(jax.nn.log_sigmoid(z) + tail), 0.0)
    return jnp.einsum('bhqk,bkhd->bqhd', weight.astype(vals.dtype), vals)


def _stick_breaking_attention(q, keys, vals, n_hist):
    B, T, H, Dh = q.shape
    nblk = -(-T // QBLOCK)
    t_pad = nblk * QBLOCK
    q_pad = jnp.pad(q, ((0, 0), (0, t_pad - T), (0, 0), (0, 0)))
    q_blocks = q_pad.reshape(B, nblk, QBLOCK, H, Dh).transpose(1, 0, 2, 3, 4)
    idx_blocks = (n_hist + jnp.arange(t_pad)).reshape(nblk, QBLOCK)
    out = lax.map(lambda a: _sb_block(a[0], a[1], keys, vals), (q_blocks, idx_blocks))
    return out.transpose(1, 0, 2, 3, 4).reshape(B, t_pad, H, Dh)[:, :T]


def _layer(h, k_hist, v_hist, u_past, n_past, w_in, b_in, w_pool_grp, pool_scale, w_br_pool, w_br_attn,
           w_out, b_out, ln1_g, ln1_b, w_mlp1, b_mlp1, w_mlp2, b_mlp2, ln2_g, ln2_b):
    B, T, _ = h.shape
    z = h @ w_in + b_in
    u, q, k, v, ga, gb = jnp.split(
        z, [POOL_W, POOL_W + ATTN_W, POOL_W + 2 * ATTN_W, POOL_W + 3 * ATTN_W,
            POOL_W + 3 * ATTN_W + D_MODEL], axis=-1)
    pooled, u_state = _multiscale_pool(u, u_past, n_past)
    pooled = pooled.reshape(B, T, N_POOL_GROUPS, POOL_GC)
    pool_out = jnp.einsum('btgc,gcd->btgd', pooled, w_pool_grp).reshape(B, T, POOL_W) * pool_scale
    q = q.reshape(B, T, SB_HEADS, SB_HEAD_DIM)
    k = k.reshape(B, T, SB_HEADS, SB_HEAD_DIM)
    v = v.reshape(B, T, SB_HEADS, SB_HEAD_DIM)
    keys = jnp.concatenate([k_hist, k], axis=1)
    vals = jnp.concatenate([v_hist, v], axis=1)
    attn = _stick_breaking_attention(q, keys, vals, k_hist.shape[1]).reshape(B, T, ATTN_W)
    mix = jax.nn.sigmoid(ga) * (pool_out @ w_br_pool) + jax.nn.sigmoid(gb) * (attn @ w_br_attn)
    h = _layer_norm(ALPHA * h + (mix @ w_out + b_out), ln1_g, ln1_b)
    f = jnp.square(jax.nn.relu(h @ w_mlp1 + b_mlp1)) @ w_mlp2 + b_mlp2
    h = _layer_norm(ALPHA * h + f, ln2_g, ln2_b)
    return h, k, v, u_state


def setup_inputs(seed: int = 0) -> dict:
    key = jax.random.key(seed)
    ks = jax.random.split(key, 24)

    def nrm(k, shape, scale):
        return jax.random.normal(k, shape, jnp.float32) * scale

    return {
        "x_prompt": nrm(ks[0], (BATCH, SEQ, D_MODEL), 1.0),
        "x_sample": nrm(ks[1], (DEC_BATCH, DEC_SEQ, D_MODEL), 1.0),
        "cache_k": nrm(ks[2], (DEPTH, DEC_BATCH, PAST_LEN, SB_HEADS, SB_HEAD_DIM), 1.0),
        "cache_v": nrm(ks[3], (DEPTH, DEC_BATCH, PAST_LEN, SB_HEADS, SB_HEAD_DIM), 1.0),
        "state_pool": nrm(ks[4], (DEPTH, DEC_BATCH, POOL_STATE, POOL_W), 1.0),
        "meta": nrm(ks[5], (N_META, D_MODEL), 1.0),
        "ln_in_g": 1.0 + nrm(ks[6], (D_MODEL,), 0.05),
        "ln_in_b": nrm(ks[7], (D_MODEL,), 0.02),
        "w_in": nrm(ks[8], (DEPTH, D_MODEL, IN_W), D_MODEL ** -0.5),
        "b_in": nrm(ks[9], (DEPTH, IN_W), 0.02),
        "w_pool_grp": nrm(ks[10], (DEPTH, N_POOL_GROUPS, POOL_GC, POOL_GC), POOL_GC ** -0.5),
        "pool_scale": 1.0 + nrm(ks[11], (DEPTH, POOL_W), 0.1),
        "w_br_pool": nrm(ks[12], (DEPTH, POOL_W, D_MODEL), POOL_W ** -0.5 * BETA_INIT),
        "w_br_attn": nrm(ks[13], (DEPTH, ATTN_W, D_MODEL), ATTN_W ** -0.5 * BETA_INIT),
        "w_out": nrm(ks[14], (DEPTH, D_MODEL, D_MODEL), D_MODEL ** -0.5 * BETA_INIT),
        "b_out": nrm(ks[15], (DEPTH, D_MODEL), 0.02),
        "ln1_g": 1.0 + nrm(ks[16], (DEPTH, D_MODEL), 0.05),
        "ln1_b": nrm(ks[17], (DEPTH, D_MODEL), 0.02),
        "w_mlp1": nrm(ks[18], (DEPTH, D_MODEL, D_FF), D_MODEL ** -0.5 * BETA_INIT),
        "b_mlp1": nrm(ks[19], (DEPTH, D_FF), 0.02),
        "w_mlp2": nrm(ks[20], (DEPTH, D_FF, D_MODEL), D_FF ** -0.5 * BETA_INIT),
        "b_mlp2": nrm(ks[21], (DEPTH, D_MODEL), 0.02),
        "ln2_g": 1.0 + nrm(ks[22], (DEPTH, D_MODEL), 0.05),
        "ln2_b": nrm(ks[23], (DEPTH, D_MODEL), 0.02),
    }


def reference(x_prompt, x_sample, cache_k, cache_v, state_pool, meta, ln_in_g, ln_in_b, w_in, b_in,
              w_pool_grp, pool_scale, w_br_pool, w_br_attn, w_out, b_out, ln1_g, ln1_b,
              w_mlp1, b_mlp1, w_mlp2, b_mlp2, ln2_g, ln2_b):
    B = x_prompt.shape[0]
    meta_rows = jnp.broadcast_to(meta.astype(x_prompt.dtype)[None], (B, N_META, D_MODEL))
    hp = _layer_norm(jnp.concatenate([meta_rows, x_prompt], axis=1), ln_in_g, ln_in_b)
    hs = _layer_norm(x_sample, ln_in_g, ln_in_b)
    kp_l, vp_l, up_l, ks_l, vs_l, us_l = [], [], [], [], [], []
    for l in range(DEPTH):
        wl = (w_in[l], b_in[l], w_pool_grp[l], pool_scale[l], w_br_pool[l], w_br_attn[l], w_out[l], b_out[l],
              ln1_g[l], ln1_b[l], w_mlp1[l], b_mlp1[l], w_mlp2[l], b_mlp2[l], ln2_g[l], ln2_b[l])
        zero_hist = jnp.zeros((B, 0, SB_HEADS, SB_HEAD_DIM), hp.dtype)
        zero_pool = jnp.zeros((B, POOL_STATE, POOL_W), hp.dtype)
        hp, kp, vp, up = _layer(hp, zero_hist, zero_hist, zero_pool, 0, *wl)
        hs, ks_, vs_, us = _layer(hs, cache_k[l], cache_v[l], state_pool[l], POOL_STATE, *wl)
        kp_l.append(kp); vp_l.append(vp); up_l.append(up)
        ks_l.append(ks_); vs_l.append(vs_); us_l.append(us)
    y_prompt = hp[:, N_META:]
    return (y_prompt, hs, jnp.stack(kp_l), jnp.stack(vp_l), jnp.stack(up_l),
            jnp.stack(ks_l), jnp.stack(vs_l), jnp.stack(us_l))
```

```cpp
#include <hip/hip_runtime.h>
#include <cstdio>
#include <cstdint>

#ifndef MK_N_LAUNCHES
#define MK_N_LAUNCHES 9
#endif

#define DBG_ATT 1
#define DBG_NPH 9
#define DBG_DUMP 1
#define LAS __attribute__((address_space(3)))
#define GAS __attribute__((address_space(1)))
typedef unsigned short bf16_t;
typedef short bf16x8 __attribute__((ext_vector_type(8)));
typedef float f32x4 __attribute__((ext_vector_type(4)));
typedef float f32x16 __attribute__((ext_vector_type(16)));
typedef unsigned u32x4 __attribute__((ext_vector_type(4)));
typedef unsigned u32x2 __attribute__((ext_vector_type(2)));
typedef _Float16 h8 __attribute__((ext_vector_type(8)));
typedef _Float16 h4 __attribute__((ext_vector_type(4)));
typedef _Float16 h2 __attribute__((ext_vector_type(2)));

constexpr int D = 1024, PB = 8, PT = 2064  , SB = 16, ST = 64, HIST = 4096, NMETA = 16, SEQ = 2048;
constexpr int PW = 512, AW = 512, NH = 8, HD = 64, FF = 4096, INW = 4096;
constexpr int RP = PB * PT;
constexpr int RS = SB * ST;
constexpr int R = RP + RS;
constexpr int MP = 17664;
constexpr float LN_EPS = 1e-5f;
constexpr float ALPHA = 1.189207115002721f;
constexpr size_t O_YP = 0, O_YS = O_YP + (size_t)PB * SEQ * D, O_KP = O_YS + (size_t)SB * ST * D, O_VP = O_KP + (size_t)RP * 512, O_PP = O_VP + (size_t)RP * 512,
                 O_KS = O_PP + (size_t)PB * 15 * 512, O_VS = O_KS + (size_t)RS * 512, O_PS = O_VS + (size_t)RS * 512, O_END = O_PS + (size_t)SB * 15 * 512;

constexpr size_t MiB = 1u << 20;
constexpr size_t WS_CTL = 0, CTL_ZERO_BYTES = 1 * MiB;
constexpr size_t WS_WIN = 2 * MiB, WS_W1 = 10 * MiB, WS_W2 = 18 * MiB, WS_WO = 26 * MiB, WS_WB = 28 * MiB, WS_WG = 30 * MiB;
constexpr size_t WS_XN = 32 * MiB;
constexpr size_t WS_HF = 68 * MiB;
constexpr size_t WS_U = 138 * MiB;
constexpr size_t WS_F1 = 32 * MiB;
constexpr size_t WS_QH = 174 * MiB, WS_KH = 192 * MiB, WS_VH = 210 * MiB;
constexpr size_t WS_G = 228 * MiB;
constexpr size_t WS_A2 = 298 * MiB;
constexpr size_t WS_T1 = 334 * MiB;
constexpr size_t WS_MIX = 370 * MiB;
constexpr size_t WS_R1 = 406 * MiB;
constexpr size_t WS_H1B = 476 * MiB;
constexpr size_t WS_END = 511 * MiB;
static_assert(WS_XN + (size_t)MP * D * 2 <= WS_HF && WS_HF + (size_t)MP * D * 4 <= WS_U && WS_U + (size_t)MP * 512 * 4 <= WS_QH && WS_F1 + (size_t)MP * FF * 2 <= WS_QH, "ws map 1");
static_assert(WS_VH + (size_t)MP * 512 * 2 <= WS_G && WS_G + (size_t)MP * 2048 * 2 <= WS_A2 && WS_A2 + (size_t)MP * D * 2 <= WS_T1 && WS_T1 + (size_t)MP * D * 2 <= WS_MIX, "ws map 2");
static_assert(WS_MIX + (size_t)MP * D * 2 <= WS_R1 && WS_R1 + (size_t)MP * D * 4 <= WS_H1B && WS_H1B + (size_t)MP * D * 2 <= WS_END, "ws map 3");
constexpr int CW_TMO = 0, CW_BAR = 4096;

constexpr int RING_BYTES = 131072, LDSCTL_OFF = RING_BYTES, MISC_OFF = LDSCTL_OFF + 320, LDS_BYTES = 147456;
constexpr int NWAVES = 8;

typedef GAS unsigned gu32;
#define RLX_AGENT __ATOMIC_RELAXED, __HIP_MEMORY_SCOPE_AGENT
#define LDS_WAIT() asm volatile("s_waitcnt lgkmcnt(0)" ::: "memory")
#define VM_WAIT() asm volatile("s_waitcnt vmcnt(0)" ::: "memory")
__device__ __forceinline__ unsigned f2bf(float f) { unsigned u = __builtin_bit_cast(unsigned, f); return (u + 0x7fffu + ((u >> 16) & 1u)) >> 16; }
__device__ __forceinline__ unsigned pk2(float lo, float hi) { return f2bf(lo) | (f2bf(hi) << 16); }
__device__ __forceinline__ float bf2f(unsigned short b) { return __builtin_bit_cast(float, (unsigned)b << 16); }
typedef float f32x2_t __attribute__((ext_vector_type(2))); typedef __bf16 bf16x2_t __attribute__((ext_vector_type(2)));
__device__ __forceinline__ unsigned cvt_pk_bf16(float lo, float hi) { f32x2_t v = {lo, hi}; bf16x2_t b = __builtin_convertvector(v, bf16x2_t); return __builtin_bit_cast(unsigned, b); }
__device__ __forceinline__ unsigned pkh2(float lo, float hi) { h2 v = {(_Float16)lo, (_Float16)hi}; return __builtin_bit_cast(unsigned, v); }
__device__ __forceinline__ float sigmoidf_(float v) { return __builtin_amdgcn_rcpf(1.0f + __expf(-v)); }

namespace pg8 {
constexpr int BM = 256, BK = 64, HALF = 128, HTB = HALF * BK * 2, STAGE_BYTES = 8 * HTB, NXCD = 8, WGM = 8;
__host__ __device__ __forceinline__ int lds_byte(int r, int c) { const int st = (r >> 4) * 2 + (c >> 5), rr = r & 15, cc = c & 31, ob = rr * 64 + cc * 2; return st * 1024 + (ob ^ (((ob >> 9) & 1) << 5)); }
__host__ __device__ __forceinline__ void stage_rc(int b, int& R_, int& C_) { const int st = b / 1024, sb = b % 1024, swz = sb ^ (((sb >> 9) & 1) << 5); R_ = (st >> 1) * 16 + swz / 64; C_ = (st & 1) * 32 + (swz % 64) / 2; }
__host__ __device__ __forceinline__ int perm32(int rho) { const int n = rho >> 4, i = rho & 15; return 8 * (i >> 2) + 4 * n + (i & 3); }

struct Unit { int pm, pn, z; };
struct Gemm { const bf16_t* A; const bf16_t* Bt; int lda, ldb, K; size_t zA, zB; };

struct StaticOrder {
    int nM, nN, nwg, G, c;
    __host__ __device__ void init(int M, int N, int G_, int c_) { nM = M / BM; nN = N / BM; nwg = nM * nN; G = G_; c = c_; }
    __host__ __device__ bool next(int i, Unit& u) const {
        const long L = (long)i * G + c; if (L >= nwg) return false;
        int wgid = (int)L; { const int q = nwg / NXCD, r = nwg % NXCD, xcd = wgid % NXCD, off = wgid / NXCD; wgid = (xcd < r ? xcd * (q + 1) : r * (q + 1) + (xcd - r) * q) + off; }
        const int nig = WGM * nN, gid = wgid / nig, fm = gid * WGM, gsz = (nM - fm) < WGM ? (nM - fm) : WGM;
        u.pm = fm + ((wgid % nig) % gsz); u.pn = (wgid % nig) / gsz; u.z = 0; return true;
    }
    __device__ __forceinline__ void a_ready(const Unit&) const {}
    __device__ __forceinline__ void done(const Unit&) const {}
};
struct PairOrder : StaticOrder {
    __host__ __device__ bool next(int i, Unit& u) const { const bool ok = StaticOrder::next(i >> 1, u); u.z = i & 1; return ok; }
};

template <class Epi, class Sched, bool ALIGN_EPI>
__device__ __forceinline__ void gemm_phase(LAS unsigned char* lds, const Gemm g, const Sched& S, const Epi& E) {
    const int tid = threadIdx.x, wid = __builtin_amdgcn_readfirstlane(tid >> 6), lane = tid & 63, wr = wid >> 2, wc = wid & 3, fr = lane & 15, fq = lane >> 4;
    const int K = g.K, nt = K / BK;
    unsigned voffA[2], voffB[2];
#pragma unroll
    for (int i = 0; i < 2; ++i) { int R_, C_; stage_rc(tid * 16 + i * 8192, R_, C_); const int Rb = (R_ & ~31) + perm32(R_ & 31);
        voffA[i] = (unsigned)(R_ * g.lda + C_) * 2u; voffB[i] = (unsigned)(Rb * g.ldb + C_) * 2u; }
    const size_t kstep = (size_t)(BK * 2);
    const size_t hA = (size_t)HALF * g.lda * 2, hB = (size_t)HALF * g.ldb * 2, tA = 2 * hA, tB = 2 * hB;
    const unsigned ldsw = (unsigned)wid * 1024u;
    const int aoff = lds_byte(wr * 64 + fr, fq * 8), boff = lds_byte(wc * 32 + fr, fq * 8);
#define PG8_SA(b, h) (((b) * 2 + (h)) * HTB)
#define PG8_SB(b, h) ((4 + (b) * 2 + (h)) * HTB)
#define PG8_STAGE(bufoff, gbase, voff) do { _Pragma("unroll") for (int _i = 0; _i < 2; ++_i) \
        __builtin_amdgcn_global_load_lds((const unsigned*)((const char*)(gbase) + (voff)[_i]), (LAS unsigned*)(lds + (bufoff) + ldsw + _i * 8192), 16, 0, 0); } while (0)
#define PG8_LDA(dst, b, h) do { _Pragma("unroll") for (int m = 0; m < 4; ++m) _Pragma("unroll") for (int k = 0; k < 2; ++k) dst[m][k] = *(const LAS bf16x8*)(lds + PG8_SA(b, h) + aoff + m * 2048 + k * 1024); } while (0)
#define PG8_LDB(dst, b, h) do { _Pragma("unroll") for (int n = 0; n < 2; ++n) _Pragma("unroll") for (int k = 0; k < 2; ++k) dst[n][k] = *(const LAS bf16x8*)(lds + PG8_SB(b, h) + boff + n * 2048 + k * 1024); } while (0)
#define PG8_MMA(ai, bj, At, Bt) do { __builtin_amdgcn_s_setprio(1); _Pragma("unroll") for (int m = 0; m < 4; ++m) _Pragma("unroll") for (int n = 0; n < 2; ++n) _Pragma("unroll") for (int k = 0; k < 2; ++k) \
        acc[ai][bj][m][n] = __builtin_amdgcn_mfma_f32_16x16x32_bf16(Bt[n][k], At[m][k], acc[ai][bj][m][n], 0, 0, 0); __builtin_amdgcn_s_setprio(0); } while (0)
#define PG8_WAIT_V(n) asm volatile("s_waitcnt vmcnt(" #n ")" ::: "memory")
#define PG8_WAIT_L(n) asm volatile("s_waitcnt lgkmcnt(" #n ")" ::: "memory")
#define PG8_BAR __builtin_amdgcn_s_barrier()
#define PG8_SCHED __builtin_amdgcn_sched_barrier(0)
    Unit cur, nxt; int ui = 0;
    if (!S.next(0, cur)) return;
    f32x4 acc[2][2][4][2];
#pragma unroll
    for (int a = 0; a < 2; ++a)
#pragma unroll
        for (int b = 0; b < 2; ++b)
#pragma unroll
            for (int m = 0; m < 4; ++m)
#pragma unroll
                for (int n = 0; n < 2; ++n) acc[a][b][m][n] = (f32x4){0.f, 0.f, 0.f, 0.f};
    bf16x8 At[4][2], B0[2][2], B1[2][2];
    const char* cA = (const char*)g.A + (size_t)cur.pm * tA + (size_t)cur.z * g.zA; const char* cB = (const char*)g.Bt + (size_t)cur.pn * tB + (size_t)cur.z * g.zB;
    S.a_ready(cur);
    PG8_STAGE(PG8_SB(0, 0), cB, voffB); PG8_STAGE(PG8_SB(0, 1), cB + hB, voffB); PG8_STAGE(PG8_SA(0, 0), cA, voffA); PG8_STAGE(PG8_SA(0, 1), cA + hA, voffA);
    if (wr == 1) PG8_BAR;
    PG8_WAIT_V(2); PG8_BAR;
    PG8_STAGE(PG8_SB(1, 0), cB + kstep, voffB); PG8_STAGE(PG8_SA(1, 0), cA + kstep, voffA); PG8_STAGE(PG8_SB(1, 1), cB + hB + kstep, voffB);
    PG8_WAIT_V(6); PG8_BAR;
    for (;;) {
        const bool has_next = S.next(ui + 1, nxt);
        const char* nA = has_next ? (const char*)g.A + (size_t)nxt.pm * tA + (size_t)nxt.z * g.zA : cA; const char* nB = has_next ? (const char*)g.Bt + (size_t)nxt.pn * tB + (size_t)nxt.z * g.zB : cB;
        for (int t = 0; t < nt; t += 2) {
            const bool last = (t == nt - 2);
            const char* a1 = cA + (size_t)(t + 1) * kstep;
            const char* a2 = last ? nA : cA + (size_t)(t + 2) * kstep; const char* b2 = last ? nB : cB + (size_t)(t + 2) * kstep;
            const char* a3 = a2 + kstep; const char* b3 = b2 + kstep;
            if (last && has_next) S.a_ready(nxt);
            PG8_LDB(B0, 0, 0); PG8_LDB(B1, 0, 1); PG8_SCHED; PG8_LDA(At, 0, 0); PG8_STAGE(PG8_SA(1, 1), a1 + hA, voffA);
            PG8_WAIT_V(8); PG8_WAIT_L(0); PG8_BAR; PG8_MMA(0, 0, At, B0); PG8_MMA(0, 1, At, B1); PG8_BAR; PG8_SCHED;
            PG8_LDA(At, 0, 1); PG8_STAGE(PG8_SB(0, 0), b2, voffB); PG8_STAGE(PG8_SB(0, 1), b2 + hB, voffB); PG8_STAGE(PG8_SA(0, 0), a2, voffA);
            PG8_WAIT_V(8); PG8_WAIT_L(0); PG8_BAR; PG8_MMA(1, 0, At, B0); PG8_MMA(1, 1, At, B1); PG8_BAR; PG8_SCHED;
            PG8_LDB(B0, 1, 0); PG8_LDB(B1, 1, 1); PG8_SCHED; PG8_LDA(At, 1, 0); PG8_STAGE(PG8_SA(0, 1), a2 + hA, voffA);
            PG8_WAIT_V(8); PG8_WAIT_L(0); PG8_BAR; PG8_MMA(0, 0, At, B0); PG8_MMA(0, 1, At, B1); PG8_BAR; PG8_SCHED;
            PG8_LDA(At, 1, 1); PG8_STAGE(PG8_SB(1, 0), b3, voffB); PG8_STAGE(PG8_SB(1, 1), b3 + hB, voffB); PG8_STAGE(PG8_SA(1, 0), a3, voffA);
            PG8_WAIT_V(8); PG8_WAIT_L(0); PG8_BAR; PG8_MMA(1, 0, At, B0); PG8_MMA(1, 1, At, B1); PG8_BAR; PG8_SCHED;
        }
        if constexpr (ALIGN_EPI) { if (wr == 0) PG8_BAR; }
        E(acc, cur, wr, wc, fr, fq); S.done(cur);
        if (!has_next) break;
#pragma unroll
        for (int a = 0; a < 2; ++a)
#pragma unroll
            for (int b = 0; b < 2; ++b)
#pragma unroll
                for (int m = 0; m < 4; ++m)
#pragma unroll
                    for (int n = 0; n < 2; ++n) acc[a][b][m][n] = (f32x4){0.f, 0.f, 0.f, 0.f};
        cur = nxt; cA = nA; cB = nB; ++ui;
        if constexpr (ALIGN_EPI) { if (wr == 1) PG8_BAR; }
    }
    PG8_WAIT_V(0);
    if constexpr (!ALIGN_EPI) { if (wr == 0) PG8_BAR; }
    PG8_BAR;
#undef PG8_SA
#undef PG8_SB
#undef PG8_STAGE
#undef PG8_LDA
#undef PG8_LDB
#undef PG8_MMA
#undef PG8_WAIT_V
#undef PG8_WAIT_L
#undef PG8_BAR
#undef PG8_SCHED
}
}

#define XB_TMO      128
#define XB_XCNT(j)  (256  + 64 * (j))
#define XB_XSUB(j)  (1280 + 64 * (j))
#define XB_XGEN(j)  (2304 + 64 * (j))
#define XB_TOP      3328
#define XB_TOPGEN   3392
#define XCD_BAR_WORDS 3456
#define XB_SPIN_CAP (1u << 18)
__device__ __forceinline__ unsigned xb_ld(unsigned* p)              { return __hip_atomic_load(p, __ATOMIC_RELAXED, __HIP_MEMORY_SCOPE_AGENT); }
__device__ __forceinline__ unsigned xb_add(unsigned* p, unsigned v) { return __hip_atomic_fetch_add(p, v, __ATOMIC_RELAXED, __HIP_MEMORY_SCOPE_AGENT); }
__device__ __forceinline__ unsigned xb_xcc_id() { return (unsigned)__builtin_amdgcn_s_getreg((3 << 11) | 20) & 0xFu; }
#define XB_SPIN(cond, bar) do { unsigned _sp = 0; while (cond) { __builtin_amdgcn_s_sleep(1); \
    if ((++_sp & 255u) == 0u) { if (xb_ld(&(bar)[XB_TMO])) break; if (_sp > XB_SPIN_CAP) { atomicAdd(&(bar)[XB_TMO], 1u); break; } } } } while (0)
struct XcdBarrier { unsigned* bar; unsigned x; volatile LAS unsigned* st; };
__device__ __forceinline__ XcdBarrier xcd_barrier_post(unsigned* bar, volatile LAS unsigned* st) {
    XcdBarrier b; b.bar = bar; b.x = xb_xcc_id(); b.st = st;
    if (threadIdx.x == 0) (void)xb_add(&bar[XB_XCNT(b.x)], 1u);
    return b;
}
__device__ __forceinline__ void xcd_barrier_complete(unsigned* bar, unsigned x, unsigned& nloc, unsigned& nx) {
    const unsigned G = gridDim.x * gridDim.y * gridDim.z;
    unsigned sum, cnt, mine, sp = 0u;
    for (;;) {
        sum = 0u; cnt = 0u; mine = 0u;
#pragma unroll
        for (unsigned j = 0; j < 16; ++j) { const unsigned c = xb_ld(&bar[XB_XCNT(j)]); sum += c; cnt += (c > 0u) ? 1u : 0u; mine = (j == x) ? c : mine; }
        if (sum == G) break;
        __builtin_amdgcn_s_sleep(1);
        if ((++sp & 255u) == 0u) { if (xb_ld(&bar[XB_TMO])) break; if (sp > XB_SPIN_CAP) { atomicAdd(&bar[XB_TMO], 1u); break; } }
    }
    nloc = mine > 0u ? mine : 1u; nx = cnt > 0u ? cnt : 1u;
}
__device__ __forceinline__ void xcd_barrier(const XcdBarrier& b) {
    asm volatile("s_waitcnt vmcnt(0)" ::: "memory");
    __syncthreads();
    if (threadIdx.x == 0) {
        unsigned* bar = b.bar;
        __builtin_amdgcn_s_waitcnt(0);
        unsigned nloc = b.st[0], nx = b.st[1];
        if (nloc == 0u) { xcd_barrier_complete(bar, b.x, nloc, nx); b.st[0] = nloc; b.st[1] = nx; }
        const unsigned old = xb_add(&bar[XB_XSUB(b.x)], 1u);
        const unsigned gen = old / nloc;
        if (old + 1u == (gen + 1u) * nloc) {
            __builtin_amdgcn_fence(__ATOMIC_RELEASE, "agent");
            asm volatile("s_waitcnt vmcnt(0)" ::: "memory");
            const unsigned og = xb_add(&bar[XB_TOP], 1u);
            const unsigned tg = og / nx;
            if (og + 1u == (tg + 1u) * nx) xb_add(&bar[XB_TOPGEN], 1u);
            else XB_SPIN(xb_ld(&bar[XB_TOPGEN]) == tg, bar);
            __builtin_amdgcn_fence(__ATOMIC_ACQUIRE, "agent");
            xb_add(&bar[XB_XGEN(b.x)], 1u);
            asm volatile("s_waitcnt vmcnt(0)" ::: "memory");
        } else {
            XB_SPIN(xb_ld(&bar[XB_XGEN(b.x)]) == gen, bar);
            __builtin_amdgcn_fence(__ATOMIC_ACQUIRE, "agent");
            asm volatile("s_waitcnt vmcnt(0)" ::: "memory");
        }
    }
    __syncthreads();
}

struct Args { const float* in[24]; float* out; unsigned char* ws; int ph_lo, ph_hi; };
struct Frame {
    LAS unsigned char* lds; int tid, lane, wave, G, bid;
    const float* const* in; float* out; unsigned char* ws;
};
__device__ __forceinline__ float wave_sum(float v) {
#pragma unroll
    for (int o = 1; o < 64; o <<= 1) v += __shfl_xor(v, o);
    return v;
}

__device__ __forceinline__ void p0_transpose_item(const float* W, int N, bf16_t* WT, int ldo, int coff, LAS float* scr, int item, int lane) {
    const int nblk = N / 32, kb = item / nblk, nb = item % nblk, k0 = 64 * kb, n0 = 32 * nb;
#pragma unroll 8
    for (int i = 0; i < 32; ++i) { const int kk = 2 * i + (lane >> 5); scr[kk * 33 + (lane & 31)] = W[(size_t)(k0 + kk) * N + n0 + (lane & 31)]; }
    LDS_WAIT(); asm volatile("" ::: "memory");
    const int c = lane & 7;
#pragma unroll
    for (int j = 0; j < 4; ++j) { const int n = (lane >> 3) + 8 * j; const LAS float* s = scr + (8 * c) * 33 + n;
        u32x4 o; o.x = pk2(s[0 * 33], s[1 * 33]); o.y = pk2(s[2 * 33], s[3 * 33]); o.z = pk2(s[4 * 33], s[5 * 33]); o.w = pk2(s[6 * 33], s[7 * 33]);
        *(u32x4*)(WT + (size_t)(n0 + n) * ldo + coff + k0 + 8 * c) = o; }
    LDS_WAIT(); asm volatile("" ::: "memory");
}
__device__ __forceinline__ const float* x_row(const Frame& F, int m) {
    if (m < RP) { const int b = m / PT, t = m - b * PT; return t < NMETA ? F.in[5] + (size_t)t * D : F.in[0] + ((size_t)b * SEQ + (t - NMETA)) * D; }
    return F.in[1] + (size_t)(m - RP) * D;
}
__device__ __forceinline__ void p0_prologue(Frame& F) {
    LAS float* scr = (LAS float*)(F.lds + F.wave * 16384);
    const int gw = F.bid * NWAVES + F.wave, NGW = F.G * NWAVES;
    bf16_t* WinT = (bf16_t*)(F.ws + WS_WIN); bf16_t* W1T = (bf16_t*)(F.ws + WS_W1); bf16_t* W2T = (bf16_t*)(F.ws + WS_W2); bf16_t* WoT = (bf16_t*)(F.ws + WS_WO); bf16_t* WbT = (bf16_t*)(F.ws + WS_WB); bf16_t* WgT = (bf16_t*)(F.ws + WS_WG);
    constexpr int I_IN = (D / 64) * (INW / 32), I_1 = (D / 64) * (FF / 32), I_2 = (FF / 64) * (D / 32), I_O = (D / 64) * (D / 32), I_B = (512 / 64) * (D / 32);
    constexpr int NITEMS = I_IN + I_1 + I_2 + I_O + 2 * I_B;
    for (int it = gw; it < NITEMS; it += NGW) {
        int r = it;
        if (r < I_IN) { p0_transpose_item(F.in[8], INW, WinT, D, 0, scr, r, F.lane); continue; } r -= I_IN;
        if (r < I_1) { p0_transpose_item(F.in[18], FF, W1T, D, 0, scr, r, F.lane); continue; } r -= I_1;
        if (r < I_2) { p0_transpose_item(F.in[20], D, W2T, FF, 0, scr, r, F.lane); continue; } r -= I_2;
        if (r < I_O) { p0_transpose_item(F.in[14], D, WoT, D, 0, scr, r, F.lane); continue; } r -= I_O;
        if (r < I_B) { p0_transpose_item(F.in[12], D, WbT, D, 0, scr, r, F.lane); continue; } r -= I_B;
        p0_transpose_item(F.in[13], D, WbT, D, 512, scr, r, F.lane);
    }
    for (int e = F.bid * 512 + F.tid; e < 4 * 128 * 128; e += F.G * 512) {
        const int g = e >> 14, d = (e >> 7) & 127, c = e & 127;
        WgT[e] = (bf16_t)f2bf(F.in[10][(size_t)(g * 128 + c) * 128 + d] * F.in[11][g * 128 + d]);
    }
    bf16_t* XN = (bf16_t*)(F.ws + WS_XN); float* HF = (float*)(F.ws + WS_HF);
    const float* lg = F.in[6]; const float* lb = F.in[7];
    for (int m = gw; m < MP; m += NGW) {
        unsigned long long* o8 = (unsigned long long*)(XN + (size_t)m * D) + F.lane; f32x4* of = (f32x4*)(HF + (size_t)m * D) + F.lane;
        if (m >= R) {
#pragma unroll
            for (int j = 0; j < 4; ++j) { o8[64 * j] = 0ull; of[64 * j] = (f32x4){0.f, 0.f, 0.f, 0.f}; }
            continue; }
        const f32x4* xr = (const f32x4*)x_row(F, m) + F.lane;
        f32x4 v[4]; float s = 0.f;
#pragma unroll
        for (int j = 0; j < 4; ++j) { v[j] = xr[64 * j]; s += (v[j].x + v[j].y) + (v[j].z + v[j].w); }
        const float mean = wave_sum(s) * (1.f / D); float s2 = 0.f;
#pragma unroll
        for (int j = 0; j < 4; ++j) { v[j] = v[j] - mean; s2 += (v[j].x * v[j].x + v[j].y * v[j].y) + (v[j].z * v[j].z + v[j].w * v[j].w); }
        const float rstd = 1.f / sqrtf(wave_sum(s2) * (1.f / D) + LN_EPS);
#pragma unroll
        for (int j = 0; j < 4; ++j) { const f32x4 gg = ((const f32x4*)lg)[F.lane + 64 * j], bb = ((const f32x4*)lb)[F.lane + 64 * j];
            const f32x4 y = v[j] * rstd * gg + bb; of[64 * j] = y;
            o8[64 * j] = (unsigned long long)pk2(y.x, y.y) | ((unsigned long long)pk2(y.z, y.w) << 32); }
    }
}

using pg8::Unit; using pg8::HALF; using pg8::BM;
struct EpiIn {
    const float* bias; float* U; unsigned short* Qh; unsigned short* Kh; unsigned short* Vh; unsigned short* Gt; float* out;
    __device__ __forceinline__ void operator()(const f32x4 (&acc)[2][2][4][2], const Unit& u, int wr, int wc, int fr, int fq) const {
        const int row0 = u.pm * BM + wr * 64 + fr, colb = u.pn * BM + wc * 32 + 8 * fq;
        f32x4 bv[2][2];
#pragma unroll
        for (int bj = 0; bj < 2; ++bj)
#pragma unroll
            for (int n = 0; n < 2; ++n) bv[bj][n] = *(const f32x4*)(bias + colb + bj * HALF + 4 * n);
        const int kind = u.pn < 2 ? 0 : u.pn < 4 ? 1 : u.pn < 6 ? 2 : u.pn < 8 ? 3 : 4;
#pragma unroll
        for (int ai = 0; ai < 2; ++ai)
#pragma unroll
            for (int m = 0; m < 4; ++m) { const int r = row0 + ai * HALF + m * 16;
#pragma unroll
                for (int bj = 0; bj < 2; ++bj) { const f32x4 v0 = acc[ai][bj][m][0] + bv[bj][0], v1 = acc[ai][bj][m][1] + bv[bj][1]; const int col = colb + bj * HALF;
                    if (kind == 0) { float* p = U + (size_t)r * 512 + col; *(f32x4*)p = v0; *(f32x4*)(p + 4) = v1; }
                    else if (kind == 1) { u32x4 w; w.x = pkh2(v0[0] * 0.125f, v0[1] * 0.125f); w.y = pkh2(v0[2] * 0.125f, v0[3] * 0.125f); w.z = pkh2(v1[0] * 0.125f, v1[1] * 0.125f); w.w = pkh2(v1[2] * 0.125f, v1[3] * 0.125f);
                        *(u32x4*)(Qh + (size_t)r * 512 + (col - 512)) = w; }
                    else if (kind == 2 || kind == 3) { const int c = col - (kind == 2 ? 1024 : 1536);
                        u32x4 w; w.x = pkh2(v0[0], v0[1]); w.y = pkh2(v0[2], v0[3]); w.z = pkh2(v1[0], v1[1]); w.w = pkh2(v1[2], v1[3]);
                        *(u32x4*)((kind == 2 ? Kh : Vh) + (size_t)r * 512 + c) = w;
                        if (r < R) { float* p = out + (r < RP ? (kind == 2 ? O_KP : O_VP) + (size_t)r * 512 : (kind == 2 ? O_KS : O_VS) + (size_t)(r - RP) * 512) + c; *(f32x4*)p = v0; *(f32x4*)(p + 4) = v1; } }
                    else { u32x4 w; w.x = pkh2(sigmoidf_(v0[0]), sigmoidf_(v0[1])); w.y = pkh2(sigmoidf_(v0[2]), sigmoidf_(v0[3])); w.z = pkh2(sigmoidf_(v1[0]), sigmoidf_(v1[1])); w.w = pkh2(sigmoidf_(v1[2]), sigmoidf_(v1[3]));
                        *(u32x4*)(Gt + (size_t)r * 2048 + (col - 2048)) = w; } } }
    }
};
struct EpiBranch {
    const unsigned short* Gt; bf16_t* T1; bf16_t* MIX;
    __device__ __forceinline__ void operator()(const f32x4 (&acc)[2][2][4][2], const Unit& u, int wr, int wc, int fr, int fq) const {
        const int row0 = u.pm * BM + wr * 64 + fr, colb = u.pn * BM + wc * 32 + 8 * fq;
#pragma unroll
        for (int ai = 0; ai < 2; ++ai)
#pragma unroll
            for (int m = 0; m < 4; ++m) { const int r = row0 + ai * HALF + m * 16;
#pragma unroll
                for (int bj = 0; bj < 2; ++bj) { const int col = colb + bj * HALF;
                    const h8 gv = *(const h8*)(Gt + (size_t)r * 2048 + u.z * 1024 + col);
                    float v[8];
#pragma unroll
                    for (int e = 0; e < 4; ++e) { v[e] = acc[ai][bj][m][0][e] * (float)gv[e]; v[4 + e] = acc[ai][bj][m][1][e] * (float)gv[4 + e]; }
                    if (u.z == 0) { u32x4 w; w.x = cvt_pk_bf16(v[0], v[1]); w.y = cvt_pk_bf16(v[2], v[3]); w.z = cvt_pk_bf16(v[4], v[5]); w.w = cvt_pk_bf16(v[6], v[7]);
                        *(u32x4*)(T1 + (size_t)r * D + col) = w; }
                    else { const u32x4 t = *(const u32x4*)(T1 + (size_t)r * D + col);
#pragma unroll
                        for (int e = 0; e < 4; ++e) { v[2 * e] += __builtin_bit_cast(float, t[e] << 16); v[2 * e + 1] += __builtin_bit_cast(float, t[e] & 0xffff0000u); }
                        u32x4 w; w.x = cvt_pk_bf16(v[0], v[1]); w.y = cvt_pk_bf16(v[2], v[3]); w.z = cvt_pk_bf16(v[4], v[5]); w.w = cvt_pk_bf16(v[6], v[7]);
                        *(u32x4*)(MIX + (size_t)r * D + col) = w; } } }
    }
};
struct EpiOut {
    const float* bias; const float* HF; float* R1;
    __device__ __forceinline__ void operator()(const f32x4 (&acc)[2][2][4][2], const Unit& u, int wr, int wc, int fr, int fq) const {
        const int row0 = u.pm * BM + wr * 64 + fr, colb = u.pn * BM + wc * 32 + 8 * fq;
#pragma unroll
        for (int ai = 0; ai < 2; ++ai)
#pragma unroll
            for (int m = 0; m < 4; ++m) { const int r = row0 + ai * HALF + m * 16;
#pragma unroll
                for (int bj = 0; bj < 2; ++bj) { const int col = colb + bj * HALF; const size_t off = (size_t)r * D + col;
                    const f32x4 b0 = *(const f32x4*)(bias + col), b1 = *(const f32x4*)(bias + col + 4), h0 = *(const f32x4*)(HF + off), h1 = *(const f32x4*)(HF + off + 4);
                    *(f32x4*)(R1 + off) = h0 * ALPHA + acc[ai][bj][m][0] + b0; *(f32x4*)(R1 + off + 4) = h1 * ALPHA + acc[ai][bj][m][1] + b1; } }
    }
};
struct EpiUp {
    const float* bias; bf16_t* F1;
    __device__ __forceinline__ void operator()(const f32x4 (&acc)[2][2][4][2], const Unit& u, int wr, int wc, int fr, int fq) const {
        const int row0 = u.pm * BM + wr * 64 + fr, colb = u.pn * BM + wc * 32 + 8 * fq;
        f32x4 bv[2][2];
#pragma unroll
        for (int bj = 0; bj < 2; ++bj)
#pragma unroll
            for (int n = 0; n < 2; ++n) bv[bj][n] = *(const f32x4*)(bias + colb + bj * HALF + 4 * n);
#pragma unroll
        for (int ai = 0; ai < 2; ++ai)
#pragma unroll
            for (int m = 0; m < 4; ++m) { const int r = row0 + ai * HALF + m * 16;
#pragma unroll
                for (int bj = 0; bj < 2; ++bj) { f32x4 v0 = acc[ai][bj][m][0] + bv[bj][0], v1 = acc[ai][bj][m][1] + bv[bj][1];
#pragma unroll
                    for (int e = 0; e < 4; ++e) { const float a = fmaxf(v0[e], 0.f), b = fmaxf(v1[e], 0.f); v0[e] = a * a; v1[e] = b * b; }
                    u32x4 w; w.x = cvt_pk_bf16(v0[0], v0[1]); w.y = cvt_pk_bf16(v0[2], v0[3]); w.z = cvt_pk_bf16(v1[0], v1[1]); w.w = cvt_pk_bf16(v1[2], v1[3]);
                    *(u32x4*)(F1 + (size_t)r * FF + colb + bj * HALF) = w; } }
    }
};
struct EpiDown {
    const float* bias; const float* H1; float* out;
    __device__ __forceinline__ void operator()(const f32x4 (&acc)[2][2][4][2], const Unit& u, int wr, int wc, int fr, int fq) const {
        const int row0 = u.pm * BM + wr * 64 + fr, colb = u.pn * BM + wc * 32 + 8 * fq;
#pragma unroll
        for (int ai = 0; ai < 2; ++ai)
#pragma unroll
            for (int m = 0; m < 4; ++m) { const int r = row0 + ai * HALF + m * 16;
                float* orow;
                if (r < RP) { const int b = r / PT, t = r - b * PT; if (t < NMETA) continue; orow = out + O_YP + ((size_t)b * SEQ + (t - NMETA)) * D; }
                else if (r < R) orow = out + O_YS + (size_t)(r - RP) * D;
                else continue;
#pragma unroll
                for (int bj = 0; bj < 2; ++bj) { const int col = colb + bj * HALF; const size_t off = (size_t)r * D + col;
                    const f32x4 b0 = *(const f32x4*)(bias + col), b1 = *(const f32x4*)(bias + col + 4), h0 = *(const f32x4*)(H1 + off), h1 = *(const f32x4*)(H1 + off + 4);
                    *(f32x4*)(orow + col) = h0 * ALPHA + acc[ai][bj][m][0] + b0; *(f32x4*)(orow + col + 4) = h1 * ALPHA + acc[ai][bj][m][1] + b1; } }
    }
};

constexpr int POOL_NRB = R / 64;
constexpr int POOL_UNITS = POOL_NRB * 4;
__device__ __forceinline__ void pool_unit(Frame& F, int unit) {
    const int rb = unit >> 2, g = unit & 3, r0 = rb * 64, w = 2 << g;
    LAS float* Uw = (LAS float*)F.lds;
    LAS unsigned short* Pl = (LAS unsigned short*)(F.lds + 40960);
    LAS unsigned short* Wl = (LAS unsigned short*)(F.lds + 40960 + 17408);
    const float* U = (const float*)(F.ws + WS_U); const bf16_t* WgT = (const bf16_t*)(F.ws + WS_WG) + (size_t)g * 128 * 128;
    bf16_t* A2 = (bf16_t*)(F.ws + WS_A2);
    for (int e = F.tid; e < 79 * 32; e += 512) { const int i = e >> 5, c4 = e & 31; const int r = r0 - 15 + i;
        f32x4 v = (f32x4){0.f, 0.f, 0.f, 0.f}; if (r >= 0) v = *(const f32x4*)(U + (size_t)r * 512 + g * 128 + c4 * 4);
        *(LAS f32x4*)(Uw + i * 128 + c4 * 4) = v; }
    for (int e = F.tid; e < 128 * 16; e += 512) { const int d = e >> 4, c8 = e & 15; *(LAS u32x4*)(Wl + d * 136 + c8 * 8) = *(const u32x4*)(WgT + d * 128 + c8 * 8); }
    __syncthreads();
    for (int e = F.tid; e < 64 * 128; e += 512) { const int i = e >> 7, c = e & 127; const int r = r0 + i;
        int b, t, npast; if (r < RP) { b = r / PT; t = r - b * PT; npast = 0; } else { const int rs = r - RP; b = rs >> 6; t = rs & 63; npast = 15; }
        float s = 0.f;
        for (int j = 0; j < w; ++j) { float x; if (t - j >= 0) x = Uw[(i + 15 - j) * 128 + c]; else x = npast ? F.in[4][((size_t)b * 15 + (15 + t - j)) * 512 + g * 128 + c] : 0.f; s += x; }
        const int cnt = min(w, npast + t + 1);
        const float p = s / (float)cnt - Uw[(i + 15) * 128 + c];
        Pl[i * 136 + c] = (unsigned short)f2bf(p); }
    __syncthreads();
    {
        const int mt = F.wave & 3, nh = F.wave >> 2, fr = F.lane & 15, fq = F.lane >> 4;
        f32x4 acc[4];
#pragma unroll
        for (int n = 0; n < 4; ++n) acc[n] = (f32x4){0.f, 0.f, 0.f, 0.f};
#pragma unroll
        for (int ks = 0; ks < 4; ++ks) { const bf16x8 pf = *(const LAS bf16x8*)(Pl + (mt * 16 + fr) * 136 + ks * 32 + fq * 8);
#pragma unroll
            for (int n = 0; n < 4; ++n) { const bf16x8 wf = *(const LAS bf16x8*)(Wl + (nh * 64 + n * 16 + fr) * 136 + ks * 32 + fq * 8);
                acc[n] = __builtin_amdgcn_mfma_f32_16x16x32_bf16(wf, pf, acc[n], 0, 0, 0); } }
        const int r = r0 + mt * 16 + fr;
#pragma unroll
        for (int n = 0; n < 4; ++n) { u32x2 o; o.x = cvt_pk_bf16(acc[n][0], acc[n][1]); o.y = cvt_pk_bf16(acc[n][2], acc[n][3]);
            *(u32x2*)(A2 + (size_t)r * D + g * 128 + nh * 64 + n * 16 + 4 * fq) = o; }
    }
    __syncthreads();
}
__device__ __forceinline__ void pool_state_rows(Frame& F) {
    const float* U = (const float*)(F.ws + WS_U);
    const int gw = F.bid * NWAVES + F.wave, NGW = F.G * NWAVES;
    for (int it = gw; it < (PB + SB) * 15; it += NGW) { const int s = it / 15, i = it - s * 15;
        const float* src; float* dst;
        if (s < PB) { src = U + ((size_t)s * PT + (PT - 15 + i)) * 512; dst = F.out + O_PP + ((size_t)s * 15 + i) * 512; }
        else { const int b = s - PB; src = U + ((size_t)RP + b * ST + (ST - 15 + i)) * 512; dst = F.out + O_PS + ((size_t)b * 15 + i) * 512; }
#pragma unroll
        for (int j = 0; j < 2; ++j) ((f32x4*)dst)[F.lane + 64 * j] = ((const f32x4*)src)[F.lane + 64 * j]; }
}

constexpr int ATT_PROMPT_QB = (PT + 255) / 256;
constexpr int ATT_UNITS_P = PB * NH * ATT_PROMPT_QB;
constexpr int ATT_UNITS = ATT_UNITS_P + SB * NH;
constexpr float ATT_STOP = -104.0f;
__device__ __forceinline__ int crow(int r, int hi) { return (r & 3) + 8 * (r >> 2) + 4 * hi; }
__device__ __forceinline__ h8 pack8(const f32x16& v, int s) { h8 o;
#pragma unroll
    for (int j = 0; j < 8; ++j) o[j] = (_Float16)v[8 * s + j];
    return o; }
__device__ __forceinline__ void attn_unit(Frame& F, int unit) {
    int row0, n_new, n_hist, b, head, q0, nq;
    if (unit < ATT_UNITS_P) { const int qb = unit % ATT_PROMPT_QB, bh = unit / ATT_PROMPT_QB; b = bh >> 3; head = bh & 7; row0 = b * PT; n_new = PT; n_hist = 0; q0 = qb * 256; nq = min(256, PT - q0); }
    else { const int bh = unit - ATT_UNITS_P; b = bh >> 3; head = bh & 7; row0 = RP + b * ST; n_new = ST; n_hist = HIST; q0 = 0; nq = ST; }
    const unsigned short* Qh = (const unsigned short*)(F.ws + WS_QH); const unsigned short* Kh = (const unsigned short*)(F.ws + WS_KH); const unsigned short* Vh = (const unsigned short*)(F.ws + WS_VH);
    bf16_t* A2 = (bf16_t*)(F.ws + WS_A2);
    const float* hk = F.in[2]; const float* hv = F.in[3];
    LAS unsigned char* Kl = F.lds;
    LAS _Float16* Vt = (LAS _Float16*)(F.lds + 8192);
    volatile LAS int* flags = (volatile LAS int*)(F.lds + 8192 + 9216);
    const int tid = F.tid, lane = F.lane, wid = F.wave, r32 = lane & 31, hi = lane >> 5;
    const int qloc = q0 + 32 * wid + r32; const bool qvalid = qloc < q0 + nq; const bool wactive = 32 * wid < nq;
    const int qidx = n_hist + qloc;
    const int qw_min = n_hist + q0 + 32 * wid, qw_max = qw_min + 31;
    h8 qf[4];
    { const size_t qrow = (size_t)row0 + min(qloc, n_new - 1);
#pragma unroll
      for (int s = 0; s < 4; ++s) qf[s] = *(const h8*)(Qh + qrow * 512 + head * 64 + 16 * s + 8 * hi); }
    h8 Uc[2], ones;
#pragma unroll
    for (int s = 0; s < 2; ++s)
#pragma unroll
        for (int j = 0; j < 8; ++j) { const int k = 16 * s + 8 * (j >> 2) + 4 * hi + (j & 3); Uc[s][j] = (k > r32) ? (_Float16)1.0f : (_Float16)0.0f; }
#pragma unroll
    for (int j = 0; j < 8; ++j) ones[j] = (_Float16)1.0f;
    f32x16 o0, o1, carry;
#pragma unroll
    for (int r = 0; r < 16; ++r) { o0[r] = 0.f; o1[r] = 0.f; carry[r] = 0.f; }
    const int kmax = n_hist + q0 + nq - 2;
    bool wdone = !wactive;
    for (int T = (kmax >> 6) * DBG_ATT - (1 - DBG_ATT); T >= 0; --T) {
        {
            const int key = tid >> 3, ch = tid & 7, kabs = 64 * T + key;
            h8 kv, vv;
            if (kabs < n_hist) { const size_t o = (((size_t)b * HIST + kabs) * NH + head) * HD + ch * 8;
                const f32x4 a0 = *(const f32x4*)(hk + o), a1 = *(const f32x4*)(hk + o + 4), c0 = *(const f32x4*)(hv + o), c1 = *(const f32x4*)(hv + o + 4);
#pragma unroll
                for (int e = 0; e < 4; ++e) { kv[e] = (_Float16)a0[e]; kv[4 + e] = (_Float16)a1[e]; vv[e] = (_Float16)c0[e]; vv[4 + e] = (_Float16)c1[e]; } }
            else { const int kn = kabs - n_hist;
                if (kn < n_new) { const size_t o = ((size_t)row0 + kn) * 512 + head * 64 + ch * 8; kv = *(const h8*)(Kh + o); vv = *(const h8*)(Vh + o); }
                else {
#pragma unroll
                    for (int e = 0; e < 8; ++e) { kv[e] = (_Float16)0.f; vv[e] = (_Float16)0.f; } } }
            *(LAS h8*)(Kl + (ch * 64 + key) * 16) = kv;
            const int i16 = key & 15, pos = (key & 48) + ((i16 >> 2) & 1) * 8 + (i16 & 3) + 4 * (i16 >> 3);
#pragma unroll
            for (int e = 0; e < 8; ++e) Vt[(ch * 8 + e) * 72 + pos] = vv[e];
        }
        __syncthreads();
        if (!wdone && 64 * T < qw_max) {
            f32x16 p0, p1;
#pragma unroll
            for (int r = 0; r < 16; ++r) { p0[r] = 0.f; p1[r] = 0.f; }
#pragma unroll
            for (int s = 0; s < 4; ++s) { const h8 k0 = *(const LAS h8*)(Kl + ((2 * s + hi) * 64 + r32) * 16), k1 = *(const LAS h8*)(Kl + ((2 * s + hi) * 64 + 32 + r32) * 16);
                p0 = __builtin_amdgcn_mfma_f32_32x32x16_f16(k0, qf[s], p0, 0, 0, 0); p1 = __builtin_amdgcn_mfma_f32_32x32x16_f16(k1, qf[s], p1, 0, 0, 0); }
            const bool need_mask = (64 * T + 63 >= qw_min) || (q0 + 32 * wid + 32 > q0 + nq);
            f32x16 l0, l1;
#pragma unroll
            for (int r = 0; r < 16; ++r) {
                const float z0 = p0[r], z1 = p1[r];
                const float sp0 = fmaxf(z0, 0.f) + __logf(1.f + __expf(-fabsf(z0))), sp1 = fmaxf(z1, 0.f) + __logf(1.f + __expf(-fabsf(z1)));
                bool v0 = true, v1 = true;
                if (need_mask) { const int k0a = 64 * T + crow(r, hi); v0 = qvalid && (k0a < qidx); v1 = qvalid && (k0a + 32 < qidx); }
                l0[r] = v0 ? -sp0 : 0.f; l1[r] = v1 ? -sp1 : 0.f;
                p0[r] = v0 ? z0 - sp0 : -1e30f; p1[r] = v1 ? z1 - sp1 : -1e30f;
            }
            const h8 x0a = pack8(l0, 0), x0b = pack8(l0, 1), x1a = pack8(l1, 0), x1b = pack8(l1, 1);
            f32x16 tmp = __builtin_amdgcn_mfma_f32_32x32x16_f16(ones, x1a, carry, 0, 0, 0); tmp = __builtin_amdgcn_mfma_f32_32x32x16_f16(ones, x1b, tmp, 0, 0, 0);
            f32x16 t1 = __builtin_amdgcn_mfma_f32_32x32x16_f16(Uc[0], x1a, carry, 0, 0, 0); t1 = __builtin_amdgcn_mfma_f32_32x32x16_f16(Uc[1], x1b, t1, 0, 0, 0);
            f32x16 t0 = __builtin_amdgcn_mfma_f32_32x32x16_f16(Uc[0], x0a, tmp, 0, 0, 0); t0 = __builtin_amdgcn_mfma_f32_32x32x16_f16(Uc[1], x0b, t0, 0, 0, 0);
            carry = __builtin_amdgcn_mfma_f32_32x32x16_f16(ones, x0a, tmp, 0, 0, 0); carry = __builtin_amdgcn_mfma_f32_32x32x16_f16(ones, x0b, carry, 0, 0, 0);
#pragma unroll
            for (int r = 0; r < 16; ++r) { p0[r] = __expf(p0[r] + t0[r]); p1[r] = __expf(p1[r] + t1[r]); }
#pragma unroll
            for (int s = 0; s < 2; ++s) { const h8 pa = pack8(p0, s), pb = pack8(p1, s);
                const h8 va0 = *(const LAS h8*)(Vt + r32 * 72 + s * 16 + hi * 8), va1 = *(const LAS h8*)(Vt + (32 + r32) * 72 + s * 16 + hi * 8);
                const h8 vb0 = *(const LAS h8*)(Vt + r32 * 72 + 32 + s * 16 + hi * 8), vb1 = *(const LAS h8*)(Vt + (32 + r32) * 72 + 32 + s * 16 + hi * 8);
                o0 = __builtin_amdgcn_mfma_f32_32x32x16_f16(pa, va0, o0, 0, 0, 0); o1 = __builtin_amdgcn_mfma_f32_32x32x16_f16(pa, va1, o1, 0, 0, 0);
                o0 = __builtin_amdgcn_mfma_f32_32x32x16_f16(pb, vb0, o0, 0, 0, 0); o1 = __builtin_amdgcn_mfma_f32_32x32x16_f16(pb, vb1, o1, 0, 0, 0); }
            wdone = __all((carry[0] < ATT_STOP) || !qvalid) != 0;
        }
        if (lane == 0) flags[wid] = wdone ? 1 : 0;
        __syncthreads();
        bool all = true;
#pragma unroll
        for (int i = 0; i < 8; ++i) all = all && (flags[i] != 0);
        if (all) break;
    }
    if (wactive) {
#pragma unroll
        for (int r = 0; r < 16; ++r) { const int ql = q0 + 32 * wid + crow(r, hi);
            if (ql < q0 + nq) { bf16_t* p = A2 + ((size_t)row0 + ql) * D + 512 + head * 64 + r32; p[0] = (bf16_t)f2bf(o0[r]); p[32] = (bf16_t)f2bf(o1[r]); } }
    }
    __syncthreads();
}

__device__ __forceinline__ void ln1_rows(Frame& F) {
    const int gw = F.bid * NWAVES + F.wave, NGW = F.G * NWAVES;
    float* R1 = (float*)(F.ws + WS_R1); bf16_t* H1B = (bf16_t*)(F.ws + WS_H1B); const float* lg = F.in[16]; const float* lb = F.in[17];
    for (int m = gw; m < MP; m += NGW) {
        unsigned long long* o8 = (unsigned long long*)(H1B + (size_t)m * D) + F.lane; f32x4* xr = (f32x4*)(R1 + (size_t)m * D) + F.lane;
        if (m >= R) {
#pragma unroll
            for (int j = 0; j < 4; ++j) o8[64 * j] = 0ull;
            continue; }
        f32x4 v[4]; float s = 0.f;
#pragma unroll
        for (int j = 0; j < 4; ++j) { v[j] = xr[64 * j]; s += (v[j].x + v[j].y) + (v[j].z + v[j].w); }
        const float mean = wave_sum(s) * (1.f / D); float s2 = 0.f;
#pragma unroll
        for (int j = 0; j < 4; ++j) { v[j] = v[j] - mean; s2 += (v[j].x * v[j].x + v[j].y * v[j].y) + (v[j].z * v[j].z + v[j].w * v[j].w); }
        const float rstd = 1.f / sqrtf(wave_sum(s2) * (1.f / D) + LN_EPS);
#pragma unroll
        for (int j = 0; j < 4; ++j) { const f32x4 gg = ((const f32x4*)lg)[F.lane + 64 * j], bb = ((const f32x4*)lb)[F.lane + 64 * j];
            const f32x4 y = v[j] * rstd * gg + bb; xr[64 * j] = y;
            o8[64 * j] = (unsigned long long)pk2(y.x, y.y) | ((unsigned long long)pk2(y.z, y.w) << 32); }
    }
}
__device__ __forceinline__ void ln2_rows(Frame& F) {
    const int gw = F.bid * NWAVES + F.wave, NGW = F.G * NWAVES;
    const float* lg = F.in[22]; const float* lb = F.in[23];
    for (int m = gw; m < PB * SEQ + SB * ST; m += NGW) {
        f32x4* xr = (f32x4*)(F.out + (size_t)m * D) + F.lane;
        f32x4 v[4]; float s = 0.f;
#pragma unroll
        for (int j = 0; j < 4; ++j) { v[j] = xr[64 * j]; s += (v[j].x + v[j].y) + (v[j].z + v[j].w); }
        const float mean = wave_sum(s) * (1.f / D); float s2 = 0.f;
#pragma unroll
        for (int j = 0; j < 4; ++j) { v[j] = v[j] - mean; s2 += (v[j].x * v[j].x + v[j].y * v[j].y) + (v[j].z * v[j].z + v[j].w * v[j].w); }
        const float rstd = 1.f / sqrtf(wave_sum(s2) * (1.f / D) + LN_EPS);
#pragma unroll
        for (int j = 0; j < 4; ++j) { const f32x4 gg = ((const f32x4*)lg)[F.lane + 64 * j], bb = ((const f32x4*)lb)[F.lane + 64 * j]; xr[64 * j] = v[j] * rstd * gg + bb; }
    }
}

constexpr int N_PHASES = 9;
__global__ void __launch_bounds__(NWAVES * 64, 2) mk_fwd(Args args) {
    extern __shared__ __attribute__((aligned(16))) unsigned char lds[];
    Frame F;
    F.lds = (LAS unsigned char*)lds; F.tid = threadIdx.x; F.lane = F.tid & 63; F.wave = __builtin_amdgcn_readfirstlane(F.tid >> 6);
    F.G = gridDim.x; F.bid = blockIdx.x; F.in = args.in; F.out = args.out; F.ws = args.ws;
    volatile LAS unsigned* MISC = (volatile LAS unsigned*)(F.lds + MISC_OFF);
    for (int u = F.tid; u < (LDS_BYTES - LDSCTL_OFF) / 4; u += NWAVES * 64) ((LAS unsigned*)(F.lds + LDSCTL_OFF))[u] = 0u;
    __syncthreads();
    XcdBarrier bar; bar.bar = (unsigned*)(F.ws + WS_CTL) + CW_BAR; bar.x = 0; bar.st = nullptr;
    const int lo = args.ph_lo, hi = args.ph_hi;
    if (hi - lo > 1) bar = xcd_barrier_post((unsigned*)(F.ws + WS_CTL) + CW_BAR, MISC + 8);
#define IN(k) (lo <= (k) && (k) < hi)
#define SEAM(k) do { if (IN(k) && IN((k) + 1)) xcd_barrier(bar); } while (0)
    bf16_t* XN = (bf16_t*)(F.ws + WS_XN); float* HF = (float*)(F.ws + WS_HF);

    if (IN(0)) { p0_prologue(F); SEAM(0); }
    if (IN(1)) {
        pg8::Gemm g{XN, (const bf16_t*)(F.ws + WS_WIN), D, D, D, 0, 0}; pg8::StaticOrder S; S.init(MP, INW, F.G, F.bid);
        EpiIn E{F.in[9], (float*)(F.ws + WS_U), (unsigned short*)(F.ws + WS_QH), (unsigned short*)(F.ws + WS_KH), (unsigned short*)(F.ws + WS_VH), (unsigned short*)(F.ws + WS_G), F.out};
        pg8::gemm_phase<EpiIn, pg8::StaticOrder, true>(F.lds, g, S, E);
        SEAM(1);
    }
    if (IN(2)) {
        for (int u = F.bid; u < ATT_UNITS; u += F.G) attn_unit(F, u);
        for (int u = F.bid; u < POOL_UNITS; u += F.G) pool_unit(F, u);
        pool_state_rows(F);
        SEAM(2);
    }
    if (IN(3)) {
        pg8::Gemm g{(const bf16_t*)(F.ws + WS_A2), (const bf16_t*)(F.ws + WS_WB), D, D, 512, 1024, 1024}; pg8::PairOrder S; S.init(MP, D, F.G, F.bid);
        EpiBranch E{(const unsigned short*)(F.ws + WS_G), (bf16_t*)(F.ws + WS_T1), (bf16_t*)(F.ws + WS_MIX)};
        pg8::gemm_phase<EpiBranch, pg8::PairOrder, true>(F.lds, g, S, E);
        SEAM(3);
    }
    if (IN(4)) {
        pg8::Gemm g{(const bf16_t*)(F.ws + WS_MIX), (const bf16_t*)(F.ws + WS_WO), D, D, D, 0, 0}; pg8::StaticOrder S; S.init(MP, D, F.G, F.bid);
        EpiOut E{F.in[15], HF, (float*)(F.ws + WS_R1)};
        pg8::gemm_phase<EpiOut, pg8::StaticOrder, true>(F.lds, g, S, E);
        SEAM(4);
    }
    if (IN(5)) { ln1_rows(F); SEAM(5); }
    if (IN(6)) {
        pg8::Gemm g{(const bf16_t*)(F.ws + WS_H1B), (const bf16_t*)(F.ws + WS_W1), D, D, D, 0, 0}; pg8::StaticOrder S; S.init(MP, FF, F.G, F.bid);
        EpiUp E{F.in[19], (bf16_t*)(F.ws + WS_F1)};
        pg8::gemm_phase<EpiUp, pg8::StaticOrder, true>(F.lds, g, S, E);
        SEAM(6);
    }
    if (IN(7)) {
        pg8::Gemm g{(const bf16_t*)(F.ws + WS_F1), (const bf16_t*)(F.ws + WS_W2), FF, FF, FF, 0, 0}; pg8::StaticOrder S; S.init(MP, D, F.G, F.bid);
        EpiDown E{F.in[21], (const float*)(F.ws + WS_R1), F.out};
        pg8::gemm_phase<EpiDown, pg8::StaticOrder, true>(F.lds, g, S, E);
        SEAM(7);
    }
    if (IN(8)) { ln2_rows(F); }
    if (IN(9)) {
        const int gw = F.bid * NWAVES + F.wave, NGW = F.G * NWAVES;
        for (int m = gw; m < PB * SEQ + SB * ST; m += NGW) { float* o = F.out + (size_t)m * D;
            for (int c = F.lane; c < D; c += 64) { float v;
                if (DBG_DUMP == 1) v = bf2f(((const bf16_t*)(F.ws + WS_A2))[(size_t)m * D + c]);
                else if (DBG_DUMP == 2) v = bf2f(((const bf16_t*)(F.ws + WS_MIX))[(size_t)m * D + c]);
                else if (DBG_DUMP == 3) v = ((const float*)(F.ws + WS_R1))[(size_t)m * D + c];
                else if (DBG_DUMP == 4) v = bf2f(((const bf16_t*)(F.ws + WS_H1B))[(size_t)m * D + c]);
                else v = bf2f(((const bf16_t*)(F.ws + WS_F1))[(size_t)m * FF + c]);
                o[c] = v; } }
    }
#undef IN
#undef SEAM
}

extern "C" void kernel_launch(void* const* d_in, const int* in_sizes, int n_in, void* d_out, int out_size, void* d_ws, size_t ws_size, hipStream_t stream) {
    static int grid = 0;
    if (grid == 0) {
        if (n_in != 24 || out_size != (int)O_END || ws_size < WS_END) { fprintf(stderr, "kernel_launch: unexpected sizes n_in %d out %d ws %zu (need %zu)\n", n_in, out_size, ws_size, (size_t)WS_END); grid = -1; return; }
        int dev = 0, cus = 0, per_cu = 0;
        if (hipGetDevice(&dev) != hipSuccess || hipDeviceGetAttribute(&cus, hipDeviceAttributeMultiprocessorCount, dev) != hipSuccess) { grid = -1; return; }
        if (hipFuncSetAttribute((const void*)mk_fwd, hipFuncAttributeMaxDynamicSharedMemorySize, LDS_BYTES) != hipSuccess) { fprintf(stderr, "kernel_launch: hipFuncSetAttribute failed\n"); grid = -1; return; }
        if (hipOccupancyMaxActiveBlocksPerMultiprocessor(&per_cu, (const void*)mk_fwd, NWAVES * 64, LDS_BYTES) != hipSuccess || per_cu < 1) { fprintf(stderr, "kernel_launch: occupancy query reports %d blocks per CU\n", per_cu); grid = -1; return; }
        (void)hipGetLastError();
        grid = cus;
    }
    if (grid < 0) return;
    (void)hipMemsetAsync((char*)d_ws + WS_CTL, 0, CTL_ZERO_BYTES, stream);
    Args a{};
    for (int i = 0; i < 24; ++i) a.in[i] = (const float*)d_in[i];
    a.out = (float*)d_out; a.ws = (unsigned char*)d_ws;
    if (MK_N_LAUNCHES == 1) { a.ph_lo = 0; a.ph_hi = N_PHASES; hipLaunchKernelGGL(mk_fwd, dim3(grid), dim3(NWAVES * 64), LDS_BYTES, stream, a); }
    else { for (int p = 0; p < DBG_NPH; ++p) { a.ph_lo = p; a.ph_hi = p + 1; hipLaunchKernelGGL(mk_fwd, dim3(grid), dim3(NWAVES * 64), LDS_BYTES, stream, a); }
        if (DBG_NPH < 9) { a.ph_lo = 9; a.ph_hi = 10; hipLaunchKernelGGL(mk_fwd, dim3(grid), dim3(NWAVES * 64), LDS_BYTES, stream, a); } }
}
```
